# Optimizing an MI355X kernel written in HIP

```python
import jax, jax.numpy as jnp
from jax import lax
import numpy as np

D_MODEL = 1024
BATCH = 8
SEQ = 4096
DEPTH = 2
DEC_BATCH = 1
DEC_SEQ = 16384
PAST_LEN = 128

GRID_W = 64
D_MIX = D_MODEL
HEAD_DIM = 64
NA_HEADS = 4
NA_ROWS = 8
NA_COLS = 16
NA_WIDTH = NA_HEADS * HEAD_DIM
FN_GROUPS = 4
FN_GROUP_DIM = 64
FN_WIDTH = FN_GROUPS * FN_GROUP_DIM
MLA_HEADS = 4
MLA_Q_LORA = 256
MLA_KV_LORA = 128
MLA_NOPE = 64
MLA_ROPE = 32
MLA_V = 64
MLA_WIDTH = MLA_HEADS * MLA_V
MLA_Q_BLOCK = 128
ROPE_THETA = 10000.0
SGU_HEADS = 4
SGU_HEAD_DIM = 64
SGU_WIDTH = SGU_HEADS * SGU_HEAD_DIM
SGU_CHUNK = 128
D_IN = 3 * NA_WIDTH + FN_WIDTH + MLA_Q_LORA + MLA_KV_LORA + MLA_ROPE + 2 * SGU_WIDTH
D_FF = 2816
CONV_WIDTH = 3
ALPHA = (2 * DEPTH) ** 0.25
BETA = (8 * DEPTH) ** -0.25
LN_EPS = 1e-5
RMS_EPS = 1e-6

kernel_name = 'hymba_natten_fnet_mla_gmlp_encoder'


def _layer_norm(x, g, b):
    xf = x.astype(jnp.float32)
    mu = jnp.mean(xf, axis=-1, keepdims=True)
    var = jnp.mean(jnp.square(xf - mu), axis=-1, keepdims=True)
    return ((xf - mu) * lax.rsqrt(var + LN_EPS) * g + b).astype(x.dtype)


def _rms_norm(x, g):
    xf = x.astype(jnp.float32)
    ms = jnp.mean(jnp.square(xf), axis=-1, keepdims=True)
    return (xf * lax.rsqrt(ms + RMS_EPS) * g).astype(x.dtype)


def _rope_tables(T):
    inv_freq = ROPE_THETA ** (-jnp.arange(0, MLA_ROPE, 2, dtype=jnp.float32) / MLA_ROPE)
    ang = jnp.arange(T, dtype=jnp.float32)[:, None] * inv_freq[None, :]
    return jnp.cos(ang), jnp.sin(ang)


def _rope(x, cos, sin):
    x1, x2 = jnp.split(x, 2, axis=-1)
    return jnp.concatenate([x1 * cos - x2 * sin, x1 * sin + x2 * cos], axis=-1).astype(x.dtype)


def _natten(q, k, v, rpb):
    B, T, H, Dh = q.shape
    rows = T // GRID_W
    kh = min(NA_ROWS, rows)
    qg = q.reshape(B, rows, GRID_W, H, Dh)
    kg = k.reshape(B, rows, GRID_W, H, Dh)
    vg = v.reshape(B, rows, GRID_W, H, Dh)
    col = jnp.arange(GRID_W)
    col_start = jnp.clip(col - NA_COLS // 2, 0, GRID_W - NA_COLS)
    col_idx = col_start[:, None] + jnp.arange(NA_COLS)[None, :]
    col_off = col_idx - col[:, None] + (NA_COLS - 1)
    scale = Dh ** -0.5

    def row_block(r):
        r_start = jnp.clip(r - kh // 2, 0, rows - kh)
        q_r = lax.dynamic_index_in_dim(qg, r, axis=1, keepdims=False)
        k_win = lax.dynamic_slice_in_dim(kg, r_start, kh, axis=1)[:, :, col_idx]
        v_win = lax.dynamic_slice_in_dim(vg, r_start, kh, axis=1)[:, :, col_idx]
        row_off = r_start + jnp.arange(kh) - r + (NA_ROWS - 1)
        bias = rpb[:, row_off][:, :, col_off]
        s = (jnp.einsum('bqhd,biqjhd->bhqij', q_r, k_win).astype(jnp.float32) * scale
             + jnp.transpose(bias, (0, 2, 1, 3)).astype(jnp.float32))
        p = jax.nn.softmax(s.reshape(B, H, GRID_W, kh * NA_COLS), axis=-1).reshape(s.shape).astype(v.dtype)
        return jnp.einsum('bhqij,biqjhd->bqhd', p, v_win)

    o = lax.map(row_block, jnp.arange(rows))
    return jnp.moveaxis(o, 0, 1).reshape(B, T, H * Dh)


def _fourier_mix(f):
    B, T, _ = f.shape
    fg = f.reshape(B, T, FN_GROUPS, FN_GROUP_DIM).astype(jnp.float32)
    out = jnp.real(jnp.fft.fft2(fg, axes=(1, 3), norm='ortho'))
    return out.reshape(B, T, FN_WIDTH).astype(f.dtype)


def _mla(cq, ckv, kr, q_g, w_uq, kv_g, w_ukv, cos, sin):
    B, T, _ = cq.shape
    q = jnp.einsum('btr,rhe->bthe', _rms_norm(cq, q_g), w_uq)
    q_nope = q[..., :MLA_NOPE]
    q_rope = _rope(q[..., MLA_NOPE:], cos[:, None, :], sin[:, None, :])
    kv = jnp.einsum('btr,rhe->bthe', _rms_norm(ckv, kv_g), w_ukv)
    k_nope = kv[..., :MLA_NOPE]
    v = kv[..., MLA_NOPE:]
    k_rope = _rope(kr, cos, sin)
    nb = T // MLA_Q_BLOCK
    scale = (MLA_NOPE + MLA_ROPE) ** -0.5

    def to_blocks(a):
        return jnp.moveaxis(a.reshape((B, nb, MLA_Q_BLOCK) + a.shape[2:]), 1, 0)

    def block(args):
        qn, qr = args
        s = jnp.einsum('bqhe,bkhe->bhqk', qn, k_nope) + jnp.einsum('bqhe,bke->bhqk', qr, k_rope)
        p = jax.nn.softmax(s.astype(jnp.float32) * scale, axis=-1).astype(v.dtype)
        return jnp.einsum('bhqk,bkhe->bqhe', p, v)

    o = lax.map(block, (to_blocks(q_nope), to_blocks(q_rope)))
    return jnp.moveaxis(o, 0, 1).reshape(B, T, MLA_WIDTH)


def _spatial_gating(z, ln_g, ln_b, w_s, b_s):
    B, T, _ = z.shape
    u, v = jnp.split(jax.nn.gelu(z), 2, axis=-1)
    v = v.reshape(B, T // SGU_CHUNK, SGU_CHUNK, SGU_HEADS, SGU_HEAD_DIM)
    v = _layer_norm(v, ln_g.reshape(SGU_HEADS, SGU_HEAD_DIM), ln_b.reshape(SGU_HEADS, SGU_HEAD_DIM))
    v = jnp.einsum('gpq,bcqgd->bcpgd', w_s, v) + b_s.T[:, :, None]
    return u * v.reshape(B, T, SGU_WIDTH)


def _mixer(h, cos, sin, w_in, na_rpb, mla_q_g, w_uq, mla_kv_g, w_ukv,
           sgu_ln_g, sgu_ln_b, sgu_w, sgu_b, w_out):
    B, T, _ = h.shape
    z = h @ w_in
    sizes = [NA_WIDTH, NA_WIDTH, NA_WIDTH, FN_WIDTH, MLA_Q_LORA, MLA_KV_LORA, MLA_ROPE, 2 * SGU_WIDTH]
    idx = [int(i) for i in np.cumsum(sizes)[:-1]]
    qa, ka, va, fb, cq, ckv, kr, sg = jnp.split(z, idx, axis=-1)
    hs = (B, T, NA_HEADS, HEAD_DIM)
    o_a = _natten(qa.reshape(hs), ka.reshape(hs), va.reshape(hs), na_rpb)
    o_b = _fourier_mix(fb)
    o_c = _mla(cq, ckv, kr, mla_q_g, w_uq, mla_kv_g, w_ukv, cos, sin)
    o_d = _spatial_gating(sg, sgu_ln_g, sgu_ln_b, sgu_w, sgu_b)
    mix = jnp.concatenate([o_a, o_b, o_c, o_d], axis=-1)
    return mix @ w_out


def _conv_ffn(x, w_up, conv_w, conv_b, w_down):
    h = x @ w_up
    hp = jnp.pad(h, ((0, 0), (CONV_WIDTH // 2, CONV_WIDTH // 2), (0, 0)))
    h = hp[:, :-2] * conv_w[0] + hp[:, 1:-1] * conv_w[1] + hp[:, 2:] * conv_w[2] + conv_b
    gate, val = jnp.split(h, 2, axis=-1)
    return (jax.nn.gelu(gate) * val) @ w_down


def _trunk(x, emb_ln_g, emb_ln_b, w_in, na_rpb, mla_q_g, w_uq, mla_kv_g, w_ukv,
           sgu_ln_g, sgu_ln_b, sgu_w, sgu_b, w_out, ln1_g, ln1_b,
           w_up, conv_w, conv_b, w_down, ln2_g, ln2_b):
    T = x.shape[1]
    cos, sin = _rope_tables(T)
    x = _layer_norm(x, emb_ln_g, emb_ln_b)
    for l in range(DEPTH):
        mix = _mixer(x, cos, sin, w_in[l], na_rpb[l], mla_q_g[l], w_uq[l], mla_kv_g[l], w_ukv[l],
                     sgu_ln_g[l], sgu_ln_b[l], sgu_w[l], sgu_b[l], w_out[l])
        x = _layer_norm(ALPHA * x + mix, ln1_g[l], ln1_b[l])
        x = _layer_norm(ALPHA * x + _conv_ffn(x, w_up[l], conv_w[l], conv_b[l], w_down[l]), ln2_g[l], ln2_b[l])
    return x


def setup_inputs(seed: int = 0) -> dict:
    key = jax.random.key(seed)
    ks = jax.random.split(key, 23)

    def nrm(k, shape, scale):
        return jax.random.normal(k, shape, jnp.float32) * scale

    L = DEPTH
    return {
        'x_prompt': nrm(ks[0], (BATCH, SEQ, D_MODEL), 1.0),
        'x_sample': nrm(ks[1], (DEC_BATCH, DEC_SEQ, D_MODEL), 1.0),
        'emb_ln_g': 1.0 + nrm(ks[2], (D_MODEL,), 0.05),
        'emb_ln_b': nrm(ks[3], (D_MODEL,), 0.02),
        'w_in': nrm(ks[4], (L, D_MODEL, D_IN), D_MODEL ** -0.5),
        'na_rpb': nrm(ks[5], (L, NA_HEADS, 2 * NA_ROWS - 1, 2 * NA_COLS - 1), 0.1),
        'mla_q_g': 1.0 + nrm(ks[6], (L, MLA_Q_LORA), 0.05),
        'w_uq': nrm(ks[7], (L, MLA_Q_LORA, MLA_HEADS, MLA_NOPE + MLA_ROPE), MLA_Q_LORA ** -0.5),
        'mla_kv_g': 1.0 + nrm(ks[8], (L, MLA_KV_LORA), 0.05),
        'w_ukv': nrm(ks[9], (L, MLA_KV_LORA, MLA_HEADS, MLA_NOPE + MLA_V), MLA_KV_LORA ** -0.5),
        'sgu_ln_g': 1.0 + nrm(ks[10], (L, SGU_WIDTH), 0.05),
        'sgu_ln_b': nrm(ks[11], (L, SGU_WIDTH), 0.02),
        'sgu_w': nrm(ks[12], (L, SGU_HEADS, SGU_CHUNK, SGU_CHUNK), SGU_CHUNK ** -0.5),
        'sgu_b': 1.0 + nrm(ks[13], (L, SGU_HEADS, SGU_CHUNK), 0.05),
        'w_out': nrm(ks[14], (L, D_MIX, D_MODEL), BETA * D_MIX ** -0.5),
        'ln1_g': 1.0 + nrm(ks[15], (L, D_MODEL), 0.05),
        'ln1_b': nrm(ks[16], (L, D_MODEL), 0.02),
        'w_up': nrm(ks[17], (L, D_MODEL, 2 * D_FF), D_MODEL ** -0.5),
        'conv_w': nrm(ks[18], (L, CONV_WIDTH, 2 * D_FF), 0.5),
        'conv_b': nrm(ks[19], (L, 2 * D_FF), 0.02),
        'w_down': nrm(ks[20], (L, D_FF, D_MODEL), BETA * D_FF ** -0.5),
        'ln2_g': 1.0 + nrm(ks[21], (L, D_MODEL), 0.05),
        'ln2_b': nrm(ks[22], (L, D_MODEL), 0.02),
    }


def reference(x_prompt, x_sample, emb_ln_g, emb_ln_b, w_in, na_rpb, mla_q_g, w_uq, mla_kv_g, w_ukv,
              sgu_ln_g, sgu_ln_b, sgu_w, sgu_b, w_out, ln1_g, ln1_b,
              w_up, conv_w, conv_b, w_down, ln2_g, ln2_b):
    y_prompt = _trunk(x_prompt, emb_ln_g, emb_ln_b, w_in, na_rpb, mla_q_g, w_uq, mla_kv_g, w_ukv,
                      sgu_ln_g, sgu_ln_b, sgu_w, sgu_b, w_out, ln1_g, ln1_b,
                      w_up, conv_w, conv_b, w_down, ln2_g, ln2_b)
    y_sample = _trunk(x_sample, emb_ln_g, emb_ln_b, w_in, na_rpb, mla_q_g, w_uq, mla_kv_g, w_ukv,
                      sgu_ln_g, sgu_ln_b, sgu_w, sgu_b, w_out, ln1_g, ln1_b,
                      w_up, conv_w, conv_b, w_down, ln2_g, ln2_b)
    return (y_prompt, y_sample)
```

```cpp
#include <hip/hip_runtime.h>
#include <hip/hip_cooperative_groups.h>
#include <cstdio>
#include <cstdint>
namespace cg = cooperative_groups;
namespace pg8 {
#define PG8_LAS __attribute__((address_space(3)))
typedef unsigned short bf16_t;
typedef short bf16x8 __attribute__((ext_vector_type(8)));
typedef float f32x4 __attribute__((ext_vector_type(4)));
typedef unsigned u32x4 __attribute__((ext_vector_type(4)));
constexpr int BM = 256, BK = 64, HALF = 128, HTB = HALF * BK * 2  , STAGE_BYTES = 8 * HTB, NXCD = 8, WGM = 8;

__host__ __device__ __forceinline__ int lds_byte(int r, int c) { const int st = (r >> 4) * 2 + (c >> 5), rr = r & 15, cc = c & 31, ob = rr * 64 + cc * 2; return st * 1024 + (ob ^ (((ob >> 9) & 1) << 5)); }
__host__ __device__ __forceinline__ void stage_rc(int b, int& R, int& C) { const int st = b / 1024, sb = b % 1024, swz = sb ^ (((sb >> 9) & 1) << 5); R = (st >> 1) * 16 + swz / 64; C = (st & 1) * 32 + (swz % 64) / 2; }
__host__ __device__ __forceinline__ int perm32(int rho) { const int n = rho >> 4, i = rho & 15; return 8 * (i >> 2) + 4 * n + (i & 3); }

struct Unit { int pm, pn; };
struct Gemm { const bf16_t* A; const bf16_t* Bt; int M, N, K, lda; };

struct StaticOrder {
    int nM, nN, nwg, G, c;
    __host__ __device__ void init(int M, int N, int G_, int c_) { nM = M / BM; nN = N / BM; nwg = nM * nN; G = G_; c = c_; }
    __host__ __device__ bool next(int i, Unit& u) const {
        const long L = (long)i * G + c; if (L >= nwg) return false;
        int wgid = (int)L; { const int q = nwg / NXCD, r = nwg % NXCD, xcd = wgid % NXCD, off = wgid / NXCD; wgid = (xcd < r ? xcd * (q + 1) : r * (q + 1) + (xcd - r) * q) + off; }
        const int nig = WGM * nN, gid = wgid / nig, fm = gid * WGM, gsz = (nM - fm) < WGM ? (nM - fm) : WGM;
        u.pm = fm + ((wgid % nig) % gsz); u.pn = (wgid % nig) / gsz; return true;
    }
    __device__ __forceinline__ void a_ready(const Unit&) const {}
    __device__ __forceinline__ void done(const Unit&) const {}
};

__device__ __forceinline__ unsigned cvt_pk_bf16(float lo, float hi) { unsigned r; asm volatile("v_cvt_pk_bf16_f32 %0, %1, %2" : "=v"(r) : "v"(lo), "v"(hi)); return r; }
typedef float f32x2 __attribute__((ext_vector_type(2)));
template <class Epi, class Sched, bool ALIGN_EPI = false, bool SP2 = false>
__device__ __forceinline__ void gemm_phase(PG8_LAS unsigned char* lds, const Gemm g, const Sched& S, const Epi& E) {
    int tid_ = threadIdx.x; asm volatile("" : "+v"(tid_));
    const int tid = tid_, wid = __builtin_amdgcn_readfirstlane(tid >> 6), lane = tid & 63, wr = wid >> 2, wc = wid & 3, fr = lane & 15, fq = lane >> 4;
    int K = g.K; asm volatile("" : "+s"(K)); const int nt = K / BK;
    unsigned voffA[2], voffB[2];
#pragma unroll
    for (int i = 0; i < 2; ++i) { int R, C; stage_rc(tid * 16 + i * 8192, R, C); const int Rb = E.perm ? ((R & ~31) + perm32(R & 31)) : R;
        voffA[i] = (unsigned)(R * g.lda + C) * 2u; voffB[i] = (unsigned)(Rb * K + C) * 2u; }
    const size_t kstep = (size_t)(BK * 2);
    const size_t hstep = (size_t)HALF * K * 2;
    const size_t tstep = 2 * hstep; const size_t hstepA = (size_t)HALF * g.lda * 2, tstepA = 2 * hstepA;
    const unsigned ldsw = (unsigned)wid * 1024u;
    const int aoff = lds_byte(wr * 64 + fr, fq * 8), boff = lds_byte(wc * 32 + fr, fq * 8);
#define PG8_SA(b, h) (((b) * 2 + (h)) * HTB)
#define PG8_SB(b, h) ((4 + (b) * 2 + (h)) * HTB)
#define PG8_STAGE(bufoff, gbase, voff) do { _Pragma("unroll") for (int _i = 0; _i < 2; ++_i) \
        __builtin_amdgcn_global_load_lds((const unsigned*)((const char*)(gbase) + (voff)[_i]), (PG8_LAS unsigned*)(lds + (bufoff) + ldsw + _i * 8192), 16, 0, 0); } while (0)
#define PG8_LDA(dst, b, h) do { _Pragma("unroll") for (int m = 0; m < 4; ++m) _Pragma("unroll") for (int k = 0; k < 2; ++k) dst[m][k] = *(const PG8_LAS bf16x8*)(lds + PG8_SA(b, h) + aoff + m * 2048 + k * 1024); } while (0)
#define PG8_LDB(dst, b, h) do { _Pragma("unroll") for (int n = 0; n < 2; ++n) _Pragma("unroll") for (int k = 0; k < 2; ++k) dst[n][k] = *(const PG8_LAS bf16x8*)(lds + PG8_SB(b, h) + boff + n * 2048 + k * 1024); } while (0)
#define PG8_MMA(ai, bj, At, Bt) do { __builtin_amdgcn_s_setprio(1); _Pragma("unroll") for (int m = 0; m < 4; ++m) _Pragma("unroll") for (int n = 0; n < 2; ++n) _Pragma("unroll") for (int k = 0; k < 2; ++k) \
        acc[ai][bj][m][n] = __builtin_amdgcn_mfma_f32_16x16x32_bf16(Bt[n][k], At[m][k], acc[ai][bj][m][n], 0, 0, 0); __builtin_amdgcn_s_setprio(0); } while (0)
#define PG8_WAIT_V(n) asm volatile("s_waitcnt vmcnt(" #n ")" ::: "memory")
#define PG8_WAIT_L(n) asm volatile("s_waitcnt lgkmcnt(" #n ")" ::: "memory")
#define PG8_BAR __builtin_amdgcn_s_barrier()
#define PG8_SCHED __builtin_amdgcn_sched_barrier(0)
    Unit cur, nxt; int ui = 0;
    if (!S.next(0, cur)) return;
    f32x4 acc[2][2][4][2];
#pragma unroll
    for (int a = 0; a < 2; ++a)
#pragma unroll
        for (int b = 0; b < 2; ++b)
#pragma unroll
            for (int m = 0; m < 4; ++m)
#pragma unroll
                for (int n = 0; n < 2; ++n) acc[a][b][m][n] = (f32x4){0.f, 0.f, 0.f, 0.f};
    bf16x8 At[4][2], B0[2][2], B1[2][2];
    const char* cA = (const char*)g.A + (size_t)cur.pm * tstepA; const char* cB = (const char*)g.Bt + (size_t)cur.pn * tstep;
    S.a_ready(cur);
    if constexpr (SP2) {
        PG8_STAGE(PG8_SB(0, 0), cB, voffB); PG8_STAGE(PG8_SB(0, 1), cB + hstep, voffB); PG8_STAGE(PG8_SA(0, 0), cA, voffA); PG8_STAGE(PG8_SA(0, 1), cA + hstepA, voffA);
        if (wr == 1) PG8_BAR;
        PG8_WAIT_V(2); PG8_BAR;
        PG8_STAGE(PG8_SB(1, 0), cB + kstep, voffB); PG8_STAGE(PG8_SA(1, 0), cA + kstep, voffA); PG8_STAGE(PG8_SB(1, 1), cB + hstep + kstep, voffB);
        PG8_WAIT_V(6); PG8_BAR;
    } else {
        PG8_STAGE(PG8_SB(0, 0), cB, voffB); PG8_STAGE(PG8_SA(0, 0), cA, voffA); PG8_STAGE(PG8_SB(0, 1), cB + hstep, voffB); PG8_STAGE(PG8_SA(0, 1), cA + hstepA, voffA);
        if (wr == 1) PG8_BAR;
        PG8_WAIT_V(4); PG8_BAR;
        PG8_STAGE(PG8_SB(1, 0), cB + kstep, voffB); PG8_STAGE(PG8_SA(1, 0), cA + kstep, voffA); PG8_STAGE(PG8_SB(1, 1), cB + hstep + kstep, voffB);
        PG8_WAIT_V(6); PG8_BAR;
    }
    for (;;) {
        const bool has_next = S.next(ui + 1, nxt);
        const char* nA = has_next ? (const char*)g.A + (size_t)nxt.pm * tstepA : cA; const char* nB = has_next ? (const char*)g.Bt + (size_t)nxt.pn * tstep : cB;
        for (int t = 0; t < nt; t += 2) {
            const bool last = (t == nt - 2);
            const char* a1 = cA + (size_t)(t + 1) * kstep;
            const char* a2 = last ? nA : cA + (size_t)(t + 2) * kstep; const char* b2 = last ? nB : cB + (size_t)(t + 2) * kstep;
            const char* a3 = a2 + kstep; const char* b3 = b2 + kstep;
            if (last && has_next) S.a_ready(nxt);
            if constexpr (SP2) {
            PG8_LDB(B0, 0, 0); PG8_LDB(B1, 0, 1); PG8_SCHED; PG8_LDA(At, 0, 0); PG8_STAGE(PG8_SA(1, 1), a1 + hstepA, voffA);
            PG8_WAIT_V(8); PG8_WAIT_L(0); PG8_BAR; PG8_MMA(0, 0, At, B0); PG8_MMA(0, 1, At, B1); PG8_BAR; PG8_SCHED;
            PG8_LDA(At, 0, 1); PG8_STAGE(PG8_SB(0, 0), b2, voffB); PG8_STAGE(PG8_SB(0, 1), b2 + hstep, voffB); PG8_STAGE(PG8_SA(0, 0), a2, voffA);
            PG8_WAIT_V(8); PG8_WAIT_L(0); PG8_BAR; PG8_MMA(1, 0, At, B0); PG8_MMA(1, 1, At, B1); PG8_BAR; PG8_SCHED;
            PG8_LDB(B0, 1, 0); PG8_LDB(B1, 1, 1); PG8_SCHED; PG8_LDA(At, 1, 0); PG8_STAGE(PG8_SA(0, 1), a2 + hstepA, voffA);
            PG8_WAIT_V(8); PG8_WAIT_L(0); PG8_BAR; PG8_MMA(0, 0, At, B0); PG8_MMA(0, 1, At, B1); PG8_BAR; PG8_SCHED;
            PG8_LDA(At, 1, 1); PG8_STAGE(PG8_SB(1, 0), b3, voffB); PG8_STAGE(PG8_SB(1, 1), b3 + hstep, voffB); PG8_STAGE(PG8_SA(1, 0), a3, voffA);
            PG8_WAIT_V(8); PG8_WAIT_L(0); PG8_BAR; PG8_MMA(1, 0, At, B0); PG8_MMA(1, 1, At, B1); PG8_BAR; PG8_SCHED;
            } else {
            PG8_LDB(B0, 0, 0); PG8_SCHED; PG8_LDA(At, 0, 0); PG8_STAGE(PG8_SA(1, 1), a1 + hstepA, voffA);
            PG8_WAIT_L(8); PG8_BAR; PG8_WAIT_L(0); PG8_MMA(0, 0, At, B0); PG8_BAR; PG8_SCHED;
            PG8_LDB(B1, 0, 1); PG8_STAGE(PG8_SB(0, 0), b2, voffB);
            PG8_BAR; PG8_WAIT_L(0); PG8_MMA(0, 1, At, B1); PG8_BAR;
            PG8_LDA(At, 0, 1); PG8_STAGE(PG8_SA(0, 0), a2, voffA);
            PG8_BAR; PG8_WAIT_L(0); PG8_MMA(1, 0, At, B0); PG8_BAR; PG8_SCHED;
            PG8_STAGE(PG8_SB(0, 1), b2 + hstep, voffB);
            PG8_WAIT_V(6); PG8_BAR; PG8_MMA(1, 1, At, B1); PG8_BAR;
            PG8_LDB(B0, 1, 0); PG8_SCHED; PG8_LDA(At, 1, 0); PG8_STAGE(PG8_SA(0, 1), a2 + hstepA, voffA);
            PG8_WAIT_L(8); PG8_BAR; PG8_WAIT_L(0); PG8_MMA(0, 0, At, B0); PG8_BAR; PG8_SCHED;
            PG8_LDB(B1, 1, 1); PG8_STAGE(PG8_SB(1, 0), b3, voffB);
            PG8_BAR; PG8_WAIT_L(0); PG8_MMA(0, 1, At, B1); PG8_BAR;
            PG8_LDA(At, 1, 1); PG8_STAGE(PG8_SA(1, 0), a3, voffA);
            PG8_BAR; PG8_WAIT_L(0); PG8_MMA(1, 0, At, B0); PG8_BAR; PG8_SCHED;
            PG8_STAGE(PG8_SB(1, 1), b3 + hstep, voffB);
            PG8_WAIT_V(6); PG8_BAR; PG8_MMA(1, 1, At, B1); PG8_BAR;
            }
        }
        if constexpr (ALIGN_EPI) { if (wr == 0) PG8_BAR; }
        if constexpr (!Epi::AFTER_DRAIN) { E(acc, cur, wr, wc, fr, fq); S.done(cur); }
        if (!has_next) break;
#pragma unroll
        for (int a = 0; a < 2; ++a)
#pragma unroll
            for (int b = 0; b < 2; ++b)
#pragma unroll
                for (int m = 0; m < 4; ++m)
#pragma unroll
                    for (int n = 0; n < 2; ++n) acc[a][b][m][n] = (f32x4){0.f, 0.f, 0.f, 0.f};
        cur = nxt; cA = nA; cB = nB; ++ui;
        if constexpr (ALIGN_EPI) { if (wr == 1) PG8_BAR; }
    }
    PG8_WAIT_V(0);
    if constexpr (!ALIGN_EPI) { if (wr == 0) PG8_BAR; }
    PG8_BAR;
    if constexpr (Epi::AFTER_DRAIN) { E.fused(acc, cur, wr, wc, fr, fq, lds, wid, lane); S.done(cur); }
#undef PG8_SA
#undef PG8_SB
#undef PG8_STAGE
#undef PG8_LDA
#undef PG8_LDB
#undef PG8_MMA
#undef PG8_WAIT_V
#undef PG8_WAIT_L
#undef PG8_BAR
#undef PG8_SCHED
}
}

#ifndef MK_MULTI
#define MK_MULTI 1
#endif
#define DEVI __device__ __forceinline__
typedef unsigned short bf16_t;
typedef short bf16x8 __attribute__((ext_vector_type(8)));
typedef float f32x4 __attribute__((ext_vector_type(4)));
typedef float f32x16 __attribute__((ext_vector_type(16)));
typedef unsigned u32x4 __attribute__((ext_vector_type(4)));
typedef unsigned u32x2 __attribute__((ext_vector_type(2)));
typedef float f32x2 __attribute__((ext_vector_type(2)));

constexpr int DM = 1024, MTOK = 49152, NPROMPT = 32768, DIN = 1952, ZP = 2048, DFF = 2816, DFF2 = 5632, DEPTH = 2;
constexpr int C_QA = 0, C_KA = 256, C_VA = 512, C_FB = 768, C_CQ = 1024, C_CKV = 1280, C_KR = 1408, C_SGU = 1440, C_SGV = 1696;
constexpr int QW = 384;
constexpr float ALPHA = 1.41421356237309515f;
constexpr float LN_EPS = 1e-5f, RMS_EPS = 1e-6f;
constexpr float LOG2E = 1.4426950408889634f;
constexpr float MLA_QSCALE = 0.10206207261596575f * LOG2E;
constexpr float NAT_SCALE = 0.125f * LOG2E;
constexpr int CHUNK_ROWS = 16384, NCHUNK = 3;

constexpr size_t MiB = 1u << 20;
constexpr size_t WS_SSQQ = 0, WS_SSQKV = 256 * 1024, WS_ROPE = 1 * MiB, WS_TW4K = 3 * MiB, WS_TW16K = 3 * MiB + 64 * 1024;
constexpr size_t WS_D64C = 3 * MiB + 256 * 1024, WS_D64S = WS_D64C + 8192, WS_D128C = 3 * MiB + 320 * 1024, WS_D128S = WS_D128C + 32768;
constexpr size_t WS_WSG = 3 * MiB + 512 * 1024;
constexpr size_t WS_W = 4 * MiB, W_LAYER = 23 * MiB;
constexpr size_t WO_IN = 0, WO_OUT = 4 * MiB, WO_UP = 6 * MiB, WO_DOWN = 17 * MiB, WO_UQ = 22 * MiB + 512 * 1024, WO_UKV = 22 * MiB + 768 * 1024;
constexpr size_t WS_XB = 50 * MiB, WS_QB = 50 * MiB, WS_KF = 86 * MiB, WS_VT = 122 * MiB;
constexpr size_t WS_Z = 146 * MiB, WS_MIX = 338 * MiB, WS_VAT = 434 * MiB, WS_FARE = 458 * MiB, WS_FAIM = 482 * MiB;
constexpr size_t WS_H = 146 * MiB, WS_G = 322 * MiB, WS_END = 512 * MiB;

DEVI unsigned pk2(float lo, float hi) { return pg8::cvt_pk_bf16(lo, hi); }
DEVI bf16_t f2bf(float x) { return (bf16_t)(pg8::cvt_pk_bf16(x, x) & 0xffffu); }
DEVI float bflo(unsigned w) { return __uint_as_float(w << 16); }
DEVI float bfhi(unsigned w) { return __uint_as_float(w & 0xffff0000u); }
DEVI float bf2f(bf16_t b) { return __uint_as_float((unsigned)b << 16); }
DEVI int ltid() { int t = threadIdx.x; asm volatile("" : "+v"(t)); return t; }
DEVI int crow(int r, int hi) { return (r & 3) + 8 * (r >> 2) + 4 * hi; }
DEVI int seq_base_of_row(int gm) { return gm < NPROMPT ? (gm & ~4095) : NPROMPT; }
DEVI int seq_len_of_row(int gm) { return gm < NPROMPT ? 4096 : 16384; }
DEVI float wave_sum(float v) {
#pragma unroll
    for (int o = 1; o < 64; o <<= 1) v += __shfl_xor(v, o);
    return v;
}
DEVI float gelu_tanh(float x) {
    const float u = 0.7978845608028654f * (x + 0.044715f * x * x * x);
    const float e = __builtin_amdgcn_exp2f(-2.0f * LOG2E * u);
    return x * __builtin_amdgcn_rcpf(1.0f + e);
}
#define MFMA32(a, b, c) __builtin_amdgcn_mfma_f32_32x32x16_bf16((a), (b), (c), 0, 0, 0)

struct Args { const float* in[23]; float* out; unsigned char* ws; int ph_lo, ph_hi; };

struct EpiZ {
    static constexpr bool PERM = true, AFTER_DRAIN = false;
    bf16_t* Z; bf16_t* VaT; float* ssq_q; float* ssq_kv;
    DEVI void operator()(const pg8::f32x4 (&acc)[2][2][4][2], const pg8::Unit& u, int wr, int wc, int fr, int fq) const {
        const int row0 = u.pm * 256 + wr * 64 + fr;
        if (u.pn == 2) {
            const int gm0 = u.pm * 256, sb = seq_base_of_row(gm0), T = seq_len_of_row(gm0);
            bf16_t* vb = VaT + (size_t)sb * 256;
#pragma unroll
            for (int ai = 0; ai < 2; ++ai)
#pragma unroll
                for (int m = 0; m < 4; ++m) { const int t = row0 + ai * 128 + m * 16 - sb;
#pragma unroll
                    for (int bj = 0; bj < 2; ++bj)
#pragma unroll
                        for (int n = 0; n < 2; ++n)
#pragma unroll
                            for (int j = 0; j < 4; ++j) { const int col = bj * 128 + wc * 32 + 8 * fq + 4 * n + j; vb[(size_t)col * T + t] = f2bf(acc[ai][bj][m][n][j]); } }
            return;
        }
        if (u.pn == 4 || u.pn == 5) {
            float* dst = (u.pn == 4) ? ssq_q : ssq_kv; const int nbj = (u.pn == 4) ? 2 : 1;
#pragma unroll
            for (int ai = 0; ai < 2; ++ai)
#pragma unroll
                for (int m = 0; m < 4; ++m) { float s = 0.f;
#pragma unroll
                    for (int bj = 0; bj < 2; ++bj) if (bj < nbj)
#pragma unroll
                        for (int n = 0; n < 2; ++n) { const pg8::f32x4 x = acc[ai][bj][m][n]; s += (x[0] * x[0] + x[1] * x[1]) + (x[2] * x[2] + x[3] * x[3]); }
                    s += __shfl_xor(s, 16); s += __shfl_xor(s, 32);
                    if (fq == 0) __hip_atomic_fetch_add(dst + row0 + ai * 128 + m * 16, s, __ATOMIC_RELAXED, __HIP_MEMORY_SCOPE_AGENT); }
        }
        const int col0 = u.pn * 256 + wc * 32 + 8 * fq;
#pragma unroll
        for (int ai = 0; ai < 2; ++ai)
#pragma unroll
            for (int m = 0; m < 4; ++m) { bf16_t* rowp = Z + (size_t)(row0 + ai * 128 + m * 16) * ZP + col0;
#pragma unroll
                for (int bj = 0; bj < 2; ++bj) { const pg8::f32x4 v0 = acc[ai][bj][m][0], v1 = acc[ai][bj][m][1];
                    u32x4 w; w.x = pk2(v0[0], v0[1]); w.y = pk2(v0[2], v0[3]); w.z = pk2(v1[0], v1[1]); w.w = pk2(v1[2], v1[3]);
                    *(u32x4*)(rowp + bj * 128) = w; } }
    }
};
struct EpiH {
    static constexpr bool PERM = true, AFTER_DRAIN = false;
    bf16_t* O; int ldc;
    DEVI void operator()(const pg8::f32x4 (&acc)[2][2][4][2], const pg8::Unit& u, int wr, int wc, int fr, int fq) const {
        const int row0 = u.pm * 256 + wr * 64 + fr, col0 = u.pn * 256 + wc * 32 + 8 * fq;
#pragma unroll
        for (int ai = 0; ai < 2; ++ai)
#pragma unroll
            for (int m = 0; m < 4; ++m) { bf16_t* rowp = O + (size_t)(row0 + ai * 128 + m * 16) * ldc + col0;
#pragma unroll
                for (int bj = 0; bj < 2; ++bj) { const pg8::f32x4 v0 = acc[ai][bj][m][0], v1 = acc[ai][bj][m][1];
                    u32x4 w; w.x = pk2(v0[0], v0[1]); w.y = pk2(v0[2], v0[3]); w.z = pk2(v1[0], v1[1]); w.w = pk2(v1[2], v1[3]);
                    *(u32x4*)(rowp + bj * 128) = w; } }
    }
};
struct EpiRes {
    static constexpr bool PERM = false, AFTER_DRAIN = false;
    float* X;
    DEVI void operator()(const pg8::f32x4 (&acc)[2][2][4][2], const pg8::Unit& u, int wr, int wc, int fr, int fq) const {
        const int row0 = u.pm * 256 + wr * 64 + fr, col0 = u.pn * 256 + wc * 32 + 4 * fq;
#pragma unroll
        for (int ai = 0; ai < 2; ++ai)
#pragma unroll
            for (int m = 0; m < 4; ++m) { float* rowp = X + (size_t)(row0 + ai * 128 + m * 16) * DM + col0;
#pragma unroll
                for (int bj = 0; bj < 2; ++bj)
#pragma unroll
                    for (int n = 0; n < 2; ++n) { pg8::f32x4* p = (pg8::f32x4*)(rowp + bj * 128 + n * 16); const pg8::f32x4 x = *p; *p = x * ALPHA + acc[ai][bj][m][n]; } }
    }
};
struct EpiQ {
    static constexpr bool PERM = false, AFTER_DRAIN = false;
    bf16_t* Qb; const float* ssq_q; const f32x2* rope;
    DEVI void operator()(const pg8::f32x4 (&acc)[2][2][4][2], const pg8::Unit& u, int wr, int wc, int fr, int fq) const {
        const int row0 = u.pm * 256 + wr * 64 + fr; const int sb = seq_base_of_row(u.pm * 256);
#pragma unroll
        for (int bj = 0; bj < 2; ++bj) { const int grp = 8 * u.pn + 4 * bj + wc; if (grp >= 12) continue;
            const bool is_rope = (grp % 3) == 2; const int col0 = grp * 32 + 4 * fq;
#pragma unroll
            for (int ai = 0; ai < 2; ++ai)
#pragma unroll
                for (int m = 0; m < 4; ++m) { const int row = row0 + ai * 128 + m * 16; asm volatile("" ::: "memory"); const float rs = MLA_QSCALE * __builtin_amdgcn_rsqf(ssq_q[row] * (1.0f / 256.0f) + RMS_EPS);
                    pg8::f32x4 v0 = acc[ai][bj][m][0] * rs, v1 = acc[ai][bj][m][1] * rs;
                    if (is_rope) { const f32x2* rp = rope + (size_t)(row - sb) * 16 + 4 * fq;
#pragma unroll
                        for (int j = 0; j < 4; ++j) { const f32x2 cs = rp[j]; const float x1 = v0[j], x2 = v1[j]; v0[j] = x1 * cs.x - x2 * cs.y; v1[j] = x1 * cs.y + x2 * cs.x; } }
                    u32x2 w0, w1; w0.x = pk2(v0[0], v0[1]); w0.y = pk2(v0[2], v0[3]); w1.x = pk2(v1[0], v1[1]); w1.y = pk2(v1[2], v1[3]);
                    bf16_t* p = Qb + (size_t)row * QW + col0; *(u32x2*)p = w0; *(u32x2*)(p + 16) = w1; } }
    }
};
struct EpiKV {
    static constexpr bool PERM = true, AFTER_DRAIN = false;
    bf16_t* Kf; bf16_t* VT; const float* ssq_kv;
    DEVI void operator()(const pg8::f32x4 (&acc)[2][2][4][2], const pg8::Unit& u, int wr, int wc, int fr, int fq) const {
        const int row0 = u.pm * 256 + wr * 64 + fr; const int sb = seq_base_of_row(u.pm * 256), T = seq_len_of_row(u.pm * 256);
#pragma unroll
        for (int ai = 0; ai < 2; ++ai)
#pragma unroll
            for (int m = 0; m < 4; ++m) { const int row = row0 + ai * 128 + m * 16; asm volatile("" ::: "memory"); const float rs = __builtin_amdgcn_rsqf(ssq_kv[row] * (1.0f / 128.0f) + RMS_EPS);
#pragma unroll
                for (int bj = 0; bj < 2; ++bj) { const int h = 2 * u.pn + bj; const pg8::f32x4 v0 = acc[ai][bj][m][0] * rs, v1 = acc[ai][bj][m][1] * rs;
                    if (wc < 2) { u32x4 w; w.x = pk2(v0[0], v0[1]); w.y = pk2(v0[2], v0[3]); w.z = pk2(v1[0], v1[1]); w.w = pk2(v1[2], v1[3]);
                        *(u32x4*)(Kf + (size_t)row * QW + h * 96 + 32 * wc + 8 * fq) = w; }
                    else { bf16_t* vb = VT + (size_t)sb * 256 + (size_t)(h * 64 + 32 * (wc - 2) + 8 * fq) * T + (row - sb);
#pragma unroll
                        for (int j = 0; j < 4; ++j) { vb[(size_t)j * T] = f2bf(v0[j]); vb[(size_t)(4 + j) * T] = f2bf(v1[j]); } } } }
    }
};

DEVI void transpose_item(const float* W, int K, int N, bf16_t* WT, const float* kscale, float* scr, int item, int lane) {
    const int nblk = N / 32, kb = item / nblk, nb = item % nblk, k0 = 64 * kb, n0 = 32 * nb;
#pragma unroll 8
    for (int i = 0; i < 32; ++i) { const int kk = 2 * i + (lane >> 5); float v = W[(size_t)(k0 + kk) * N + n0 + (lane & 31)]; if (kscale) v *= kscale[k0 + kk]; scr[kk * 33 + (lane & 31)] = v; }
    asm volatile("s_waitcnt lgkmcnt(0)" ::: "memory");
    const int c = lane & 7;
#pragma unroll
    for (int j = 0; j < 4; ++j) { const int n = (lane >> 3) + 8 * j; const float* s = scr + (8 * c) * 33 + n;
        u32x4 o; o.x = pk2(s[0 * 33], s[1 * 33]); o.y = pk2(s[2 * 33], s[3 * 33]); o.z = pk2(s[4 * 33], s[5 * 33]); o.w = pk2(s[6 * 33], s[7 * 33]);
        *(u32x4*)(WT + (size_t)(n0 + n) * K + k0 + 8 * c) = o; }
    asm volatile("s_waitcnt lgkmcnt(0)" ::: "memory");
}
DEVI void ln_row(const float* src, float* dstf, bf16_t* dstb, const float* g, const float* b, int lane) {
    const f32x4* xr = (const f32x4*)src + lane;
    f32x4 v[4]; float s = 0.f;
#pragma unroll
    for (int j = 0; j < 4; ++j) { v[j] = xr[64 * j]; s += (v[j].x + v[j].y) + (v[j].z + v[j].w); }
    const float mean = wave_sum(s) * (1.f / DM); float s2 = 0.f;
#pragma unroll
    for (int j = 0; j < 4; ++j) { v[j] = v[j] - mean; s2 += (v[j].x * v[j].x + v[j].y * v[j].y) + (v[j].z * v[j].z + v[j].w * v[j].w); }
    const float rstd = 1.f / sqrtf(wave_sum(s2) * (1.f / DM) + LN_EPS);
#pragma unroll
    for (int j = 0; j < 4; ++j) { const f32x4 gg = ((const f32x4*)g)[lane + 64 * j], bb = ((const f32x4*)b)[lane + 64 * j];
        const f32x4 o = v[j] * rstd * gg + bb; ((f32x4*)dstf)[lane + 64 * j] = o;
        u32x2 w; w.x = pk2(o.x, o.y); w.y = pk2(o.z, o.w); ((u32x2*)dstb)[lane + 64 * j] = w; }
}

template <int DQK, bool NAT>
DEVI void attn_unit(unsigned char* lds, const bf16_t* Qw, int ldq, const bf16_t* Kb, int ldk, const bf16_t* VTb, int T, int nkt,
                    bf16_t* Ow, int ldo, const float* rpbs, int j_lo, int rioff) {
    const int tid = ltid(), lane = tid & 63, l31 = lane & 31, hi = lane >> 5, wid = tid >> 6;
    constexpr int KROW = DQK * 2 + 16, VROW = 144, KCH = DQK / 8, ND0 = DQK / 16;
    unsigned char* Ks = lds; unsigned char* Vs = lds + 2 * 64 * KROW;
    bf16x8 qr[ND0];
#pragma unroll
    for (int d0 = 0; d0 < ND0; ++d0) qr[d0] = *(const bf16x8*)(Qw + (size_t)l31 * ldq + d0 * 16 + hi * 8);
    const int kc0 = tid, kkey0 = kc0 / KCH, kpart0 = kc0 % KCH;
    const int kc1 = 512 + tid, kkey1 = kc1 / KCH, kpart1 = kc1 % KCH; const bool has_k1 = (DQK == 96) && (tid < 256);
    const int vd = tid >> 3, vpart = tid & 7;
    const bf16_t* gk0 = Kb + (size_t)kkey0 * ldk + kpart0 * 8; const bf16_t* gk1 = Kb + (size_t)kkey1 * ldk + kpart1 * 8;
    const bf16_t* gv = VTb + (size_t)vd * T + vpart * 8;
    const int lk0 = kkey0 * KROW + kpart0 * 16, lk1 = kkey1 * KROW + kpart1 * 16, lv = vd * VROW + vpart * 16;
    u32x4 sk0, sk1 = (u32x4){0u, 0u, 0u, 0u}, sv;
#define AT_GLOAD(j) do { sk0 = *(const u32x4*)(gk0 + (size_t)(j) * 64 * ldk); if (has_k1) sk1 = *(const u32x4*)(gk1 + (size_t)(j) * 64 * ldk); sv = *(const u32x4*)(gv + (size_t)(j) * 64); } while (0)
#define AT_LSTORE(b) do { *(u32x4*)(Ks + (b) * 64 * KROW + lk0) = sk0; if (has_k1) *(u32x4*)(Ks + (b) * 64 * KROW + lk1) = sk1; *(u32x4*)(Vs + (b) * 64 * VROW + lv) = sv; } while (0)
    float m_run = -INFINITY, l_run = 0.f;
    f32x16 o0, o1;
#pragma unroll
    for (int r = 0; r < 16; ++r) { o0[r] = 0.f; o1[r] = 0.f; }
    const int qc = 32 * (wid & 1) + l31; const int cs = min(max(qc - 8, 0), 48);
    __syncthreads();
    AT_GLOAD(0); AT_LSTORE(0);
    __syncthreads();
    for (int j = 0; j < nkt; ++j) {
        const int buf = j & 1;
        if (j + 1 < nkt) AT_GLOAD(j + 1);
        const bool active = !NAT || (j >= j_lo && j < j_lo + 8);
        if (active) {
            const unsigned char* Kt = Ks + buf * 64 * KROW + l31 * KROW + hi * 16;
            const unsigned char* Vt = Vs + buf * 64 * VROW + l31 * VROW + hi * 8;
            f32x16 p0, p1;
#pragma unroll
            for (int r = 0; r < 16; ++r) { p0[r] = 0.f; p1[r] = 0.f; }
#pragma unroll
            for (int d0 = 0; d0 < ND0; ++d0) {
                const bf16x8 k0 = *(const bf16x8*)(Kt + d0 * 32), k1 = *(const bf16x8*)(Kt + 32 * KROW + d0 * 32);
                p0 = MFMA32(k0, qr[d0], p0); p1 = MFMA32(k1, qr[d0], p1);
            }
            if (NAT) {
                const float* bt = rpbs + (j + rioff) * 32 + 15 - qc;
#pragma unroll
                for (int r = 0; r < 16; ++r) { const int kc = crow(r, hi);
                    { const bool ok = (kc >= cs) && (kc < cs + 16); const int ix = ok ? kc : qc; const float bv = bt[ix]; p0[r] = ok ? p0[r] * NAT_SCALE + bv : -INFINITY; }
                    { const int kc2 = kc + 32; const bool ok = (kc2 >= cs) && (kc2 < cs + 16); const int ix = ok ? kc2 : qc; const float bv = bt[ix]; p1[r] = ok ? p1[r] * NAT_SCALE + bv : -INFINITY; } }
            }
            float mx = fmaxf(p0[0], p1[0]);
#pragma unroll
            for (int r = 1; r < 16; ++r) mx = fmaxf(mx, fmaxf(p0[r], p1[r]));
            mx = fmaxf(mx, __shfl_xor(mx, 32));
            const float mnew = fmaxf(m_run, mx), alpha = __builtin_amdgcn_exp2f(m_run - mnew); m_run = mnew;
            float ls = 0.f;
#pragma unroll
            for (int r = 0; r < 16; ++r) { p0[r] = __builtin_amdgcn_exp2f(p0[r] - mnew); p1[r] = __builtin_amdgcn_exp2f(p1[r] - mnew); ls += p0[r] + p1[r]; }
            l_run = l_run * alpha + ls;
#pragma unroll
            for (int r = 0; r < 16; ++r) { o0[r] *= alpha; o1[r] *= alpha; }
            u32x4 pw[4];
            pw[0] = (u32x4){pk2(p0[0], p0[1]), pk2(p0[2], p0[3]), pk2(p0[4], p0[5]), pk2(p0[6], p0[7])};
            pw[1] = (u32x4){pk2(p0[8], p0[9]), pk2(p0[10], p0[11]), pk2(p0[12], p0[13]), pk2(p0[14], p0[15])};
            pw[2] = (u32x4){pk2(p1[0], p1[1]), pk2(p1[2], p1[3]), pk2(p1[4], p1[5]), pk2(p1[6], p1[7])};
            pw[3] = (u32x4){pk2(p1[8], p1[9]), pk2(p1[10], p1[11]), pk2(p1[12], p1[13]), pk2(p1[14], p1[15])};
#pragma unroll
            for (int kk = 0; kk < 4; ++kk) {
                const bf16x8 pf = __builtin_bit_cast(bf16x8, pw[kk]);
                const u32x2 a0 = *(const u32x2*)(Vt + kk * 32), a1 = *(const u32x2*)(Vt + kk * 32 + 16);
                const u32x2 b0 = *(const u32x2*)(Vt + 32 * VROW + kk * 32), b1 = *(const u32x2*)(Vt + 32 * VROW + kk * 32 + 16);
                const bf16x8 va = __builtin_bit_cast(bf16x8, (u32x4){a0.x, a0.y, a1.x, a1.y}), vb = __builtin_bit_cast(bf16x8, (u32x4){b0.x, b0.y, b1.x, b1.y});
                o0 = MFMA32(va, pf, o0); o1 = MFMA32(vb, pf, o1);
            }
        }
        if (j + 1 < nkt) AT_LSTORE(buf ^ 1);
        __syncthreads();
    }
#undef AT_GLOAD
#undef AT_LSTORE
    l_run += __shfl_xor(l_run, 32);
    const float inv = 1.0f / l_run;
    bf16_t* op = Ow + (size_t)l31 * ldo + 4 * hi;
#pragma unroll
    for (int qd = 0; qd < 4; ++qd) {
        u32x2 w0, w1; w0.x = pk2(o0[4 * qd] * inv, o0[4 * qd + 1] * inv); w0.y = pk2(o0[4 * qd + 2] * inv, o0[4 * qd + 3] * inv);
        w1.x = pk2(o1[4 * qd] * inv, o1[4 * qd + 1] * inv); w1.y = pk2(o1[4 * qd + 2] * inv, o1[4 * qd + 3] * inv);
        *(u32x2*)(op + 8 * qd) = w0; *(u32x2*)(op + 32 + 8 * qd) = w1;
    }
}

DEVI void sgu_item(unsigned char* lds, int item, const bf16_t* Z, const bf16_t* Wsg, const float* ln_g, const float* ln_b, const float* b_s, bf16_t* MIX) {
    const int tid = ltid(), lane = tid & 63, l31 = lane & 31, hi = lane >> 5, wid = tid >> 6;
    const int ck = item >> 2, g = item & 3, R0 = ck * 128;
    constexpr int VROW = 272;
    __syncthreads();
    {
        const int q = tid >> 2, qt = tid & 3;
        const bf16_t* src = Z + (size_t)(R0 + q) * ZP + C_SGV + g * 64 + qt * 16;
        const u32x4 w0 = *(const u32x4*)src, w1 = *(const u32x4*)(src + 8);
        float v[16];
        v[0] = bflo(w0.x); v[1] = bfhi(w0.x); v[2] = bflo(w0.y); v[3] = bfhi(w0.y); v[4] = bflo(w0.z); v[5] = bfhi(w0.z); v[6] = bflo(w0.w); v[7] = bfhi(w0.w);
        v[8] = bflo(w1.x); v[9] = bfhi(w1.x); v[10] = bflo(w1.y); v[11] = bfhi(w1.y); v[12] = bflo(w1.z); v[13] = bfhi(w1.z); v[14] = bflo(w1.w); v[15] = bfhi(w1.w);
        float s = 0.f;
#pragma unroll
        for (int i = 0; i < 16; ++i) { v[i] = gelu_tanh(v[i]); s += v[i]; }
        s += __shfl_xor(s, 1); s += __shfl_xor(s, 2);
        const float mean = s * (1.0f / 64.0f); float s2 = 0.f;
#pragma unroll
        for (int i = 0; i < 16; ++i) { v[i] -= mean; s2 += v[i] * v[i]; }
        s2 += __shfl_xor(s2, 1); s2 += __shfl_xor(s2, 2);
        const float rstd = 1.0f / sqrtf(s2 * (1.0f / 64.0f) + LN_EPS);
#pragma unroll
        for (int i = 0; i < 16; ++i) { const int d = qt * 16 + i; const float o = v[i] * rstd * ln_g[g * 64 + d] + ln_b[g * 64 + d];
            *(bf16_t*)(lds + d * VROW + q * 2) = f2bf(o); }
    }
    __syncthreads();
    const int mt = wid >> 1, nt = wid & 1;
    f32x16 c;
#pragma unroll
    for (int r = 0; r < 16; ++r) c[r] = 0.f;
    const bf16_t* wa = Wsg + (size_t)g * 16384 + (size_t)(32 * mt + l31) * 128 + hi * 8;
    const unsigned char* vb = lds + (32 * nt + l31) * VROW + hi * 16;
#pragma unroll
    for (int kk = 0; kk < 8; ++kk) { const bf16x8 a = *(const bf16x8*)(wa + kk * 16), b = *(const bf16x8*)(vb + kk * 32); c = MFMA32(a, b, c); }
    const int d = 32 * nt + l31;
#pragma unroll
    for (int r = 0; r < 16; ++r) { const int p = 32 * mt + crow(r, hi); const size_t row = (size_t)(R0 + p);
        const float uu = gelu_tanh(bf2f(Z[row * ZP + C_SGU + g * 64 + d]));
        MIX[row * DM + 768 + g * 64 + d] = f2bf(uu * (c[r] + b_s[g * 128 + p])); }
}

template <int N>
DEVI void fft1_item(unsigned char* lds, int sb, int t2b, int cb, const bf16_t* Z, const bf16_t* Dc, const bf16_t* Ds, const f32x2* tw, bf16_t* FAre, bf16_t* FAim) {
    const int tid = ltid(), lane = tid & 63, l31 = lane & 31, hi = lane >> 5, wid = tid >> 6;
    constexpr int CB = (N == 64) ? 64 : 32, NCOL = 8 * CB, XROW = N * 2 + 16, NT = N * N, NMT = N / 32, NNT = NCOL / 256;
    const int t20 = t2b * 8;
    __syncthreads();
    for (int task = tid; task < (NCOL / 2) * (N / 8); task += 512) {
        const int cp = task % (NCOL / 2), o = task / (NCOL / 2); const int col = 2 * cp, t2l = col / CB, cl = col % CB;
        const bf16_t* src = Z + (size_t)(sb + t20 + t2l) * ZP + C_FB + cb * CB + cl;
        unsigned w[8];
#pragma unroll
        for (int i = 0; i < 8; ++i) w[i] = *(const unsigned*)(src + (size_t)(8 * o + i) * N * ZP);
        u32x4 lo, hh;
        lo.x = (w[0] & 0xffffu) | (w[1] << 16); lo.y = (w[2] & 0xffffu) | (w[3] << 16); lo.z = (w[4] & 0xffffu) | (w[5] << 16); lo.w = (w[6] & 0xffffu) | (w[7] << 16);
        hh.x = (w[0] >> 16) | (w[1] & 0xffff0000u); hh.y = (w[2] >> 16) | (w[3] & 0xffff0000u); hh.z = (w[4] >> 16) | (w[5] & 0xffff0000u); hh.w = (w[6] >> 16) | (w[7] & 0xffff0000u);
        *(u32x4*)(lds + col * XROW + o * 16) = lo; *(u32x4*)(lds + (col + 1) * XROW + o * 16) = hh;
    }
    __syncthreads();
    const int wcol0 = wid * (NCOL / 8);
#pragma unroll 1
    for (int a = 0; a < NMT; ++a) {
        f32x16 ac[NNT], as[NNT];
#pragma unroll
        for (int b = 0; b < NNT; ++b)
#pragma unroll
            for (int r = 0; r < 16; ++r) { ac[b][r] = 0.f; as[b][r] = 0.f; }
#pragma unroll
        for (int kk = 0; kk < N / 16; ++kk) {
            const bf16x8 fc = *(const bf16x8*)(Dc + (size_t)(32 * a + l31) * N + kk * 16 + hi * 8), fs = *(const bf16x8*)(Ds + (size_t)(32 * a + l31) * N + kk * 16 + hi * 8);
#pragma unroll
            for (int b = 0; b < NNT; ++b) { const bf16x8 bx = *(const bf16x8*)(lds + (wcol0 + 32 * b + l31) * XROW + kk * 32 + hi * 16);
                ac[b] = MFMA32(fc, bx, ac[b]); as[b] = MFMA32(fs, bx, as[b]); }
        }
#pragma unroll
        for (int b = 0; b < NNT; ++b) { const int col = wcol0 + 32 * b + l31, t2 = t20 + col / CB, cl = col % CB;
#pragma unroll
            for (int r = 0; r < 16; ++r) { const int k1 = 32 * a + crow(r, hi); const f32x2 w = tw[(k1 * t2) & (NT - 1)];
                const float re = ac[b][r], im = -as[b][r]; const float re2 = re * w.x + im * w.y, im2 = im * w.x - re * w.y;
                const size_t off = (size_t)(sb + k1 * N + t2) * 256 + cb * CB + cl; FAre[off] = f2bf(re2); FAim[off] = f2bf(im2);
                if ((r & 3) == 3) asm volatile("" ::: "memory"); } }
    }
}

template <int N>
DEVI void fft2_item(unsigned char* lds, int sb, int k1, int g, const bf16_t* FAre, const bf16_t* FAim, const bf16_t* Dc, const bf16_t* Ds, const bf16_t* D64c, const bf16_t* D64s, bf16_t* MIX) {
    const int tid = ltid(), lane = tid & 63, l31 = lane & 31, hi = lane >> 5, wid = tid >> 6;
    constexpr int AROW = N * 2 + 16, FROW = 144, NTILE = 2 * (N / 32);
    unsigned char* ATre = lds; unsigned char* ATim = lds + 64 * AROW; unsigned char* FTre = lds + 2 * 64 * AROW; unsigned char* FTim = FTre + N * FROW;
    const float norm = (N == 64) ? (1.0f / 512.0f) : (1.0f / 1024.0f);
    __syncthreads();
    for (int task = tid; task < 32 * (N / 8) * 2; task += 512) {
        const int cp = task & 31, o = (task >> 5) % (N / 8), pl = task / (32 * (N / 8));
        const bf16_t* src = (pl ? FAim : FAre) + (size_t)(sb + k1 * N + 8 * o) * 256 + g * 64 + 2 * cp;
        unsigned w[8];
#pragma unroll
        for (int i = 0; i < 8; ++i) w[i] = *(const unsigned*)(src + (size_t)i * 256);
        u32x4 lo, hh;
        lo.x = (w[0] & 0xffffu) | (w[1] << 16); lo.y = (w[2] & 0xffffu) | (w[3] << 16); lo.z = (w[4] & 0xffffu) | (w[5] << 16); lo.w = (w[6] & 0xffffu) | (w[7] << 16);
        hh.x = (w[0] >> 16) | (w[1] & 0xffff0000u); hh.y = (w[2] >> 16) | (w[3] & 0xffff0000u); hh.z = (w[4] >> 16) | (w[5] & 0xffff0000u); hh.w = (w[6] >> 16) | (w[7] & 0xffff0000u);
        unsigned char* dst = (pl ? ATim : ATre) + (2 * cp) * AROW + o * 16;
        *(u32x4*)dst = lo; *(u32x4*)(dst + AROW) = hh;
    }
    __syncthreads();
    if (wid < NTILE) {
        const int mt = wid & 1, nt = wid >> 1;
        f32x16 fr, fp, fn;
#pragma unroll
        for (int r = 0; r < 16; ++r) { fr[r] = 0.f; fp[r] = 0.f; fn[r] = 0.f; }
#pragma unroll
        for (int kk = 0; kk < N / 16; ++kk) {
            const bf16x8 are = *(const bf16x8*)(ATre + (32 * mt + l31) * AROW + kk * 32 + hi * 16), aim = *(const bf16x8*)(ATim + (32 * mt + l31) * AROW + kk * 32 + hi * 16);
            const bf16x8 bc = *(const bf16x8*)(Dc + (size_t)(32 * nt + l31) * N + kk * 16 + hi * 8), bs = *(const bf16x8*)(Ds + (size_t)(32 * nt + l31) * N + kk * 16 + hi * 8);
            fr = MFMA32(are, bc, fr); fr = MFMA32(aim, bs, fr); fp = MFMA32(aim, bc, fp); fn = MFMA32(are, bs, fn);
        }
        const int k2 = 32 * nt + l31;
#pragma unroll
        for (int qd = 0; qd < 4; ++qd) { const int c0 = 32 * mt + 8 * qd + 4 * hi;
            u32x2 wr_, wi_; wr_.x = pk2(fr[4 * qd], fr[4 * qd + 1]); wr_.y = pk2(fr[4 * qd + 2], fr[4 * qd + 3]);
            wi_.x = pk2(fp[4 * qd] - fn[4 * qd], fp[4 * qd + 1] - fn[4 * qd + 1]); wi_.y = pk2(fp[4 * qd + 2] - fn[4 * qd + 2], fp[4 * qd + 3] - fn[4 * qd + 3]);
            *(u32x2*)(FTre + k2 * FROW + c0 * 2) = wr_; *(u32x2*)(FTim + k2 * FROW + c0 * 2) = wi_; }
    }
    __syncthreads();
    if (wid < NTILE) {
        const int nt3 = wid & 1, mt3 = wid >> 1;
        f32x16 c;
#pragma unroll
        for (int r = 0; r < 16; ++r) c[r] = 0.f;
#pragma unroll
        for (int kk = 0; kk < 4; ++kk) {
            const bf16x8 are = *(const bf16x8*)(FTre + (32 * mt3 + l31) * FROW + kk * 32 + hi * 16), aim = *(const bf16x8*)(FTim + (32 * mt3 + l31) * FROW + kk * 32 + hi * 16);
            const bf16x8 bc = *(const bf16x8*)(D64c + (size_t)(32 * nt3 + l31) * 64 + kk * 16 + hi * 8), bs = *(const bf16x8*)(D64s + (size_t)(32 * nt3 + l31) * 64 + kk * 16 + hi * 8);
            c = MFMA32(are, bc, c); c = MFMA32(aim, bs, c);
        }
        const int cc = 32 * nt3 + l31;
#pragma unroll
        for (int r = 0; r < 16; ++r) { const int k2 = 32 * mt3 + crow(r, hi); MIX[(size_t)(sb + k1 + N * k2) * DM + 256 + g * 64 + cc] = f2bf(c[r] * norm); }
    }
}

DEVI void gate_item(int item, int chunk_row0, const bf16_t* H, bf16_t* G, const float* conv_w, const float* conv_b, int lane) {
    const int run = item / 6, cblk = item % 6; const int c0 = (cblk * 64 + lane) * 8;
    if (c0 >= DFF) return;
    float wg[3][8], wv[3][8], bg[8], bv[8];
#pragma unroll
    for (int j = 0; j < 3; ++j)
#pragma unroll
        for (int i = 0; i < 8; ++i) { wg[j][i] = conv_w[j * DFF2 + c0 + i]; wv[j][i] = conv_w[j * DFF2 + DFF + c0 + i]; }
#pragma unroll
    for (int i = 0; i < 8; ++i) { bg[i] = conv_b[c0 + i]; bv[i] = conv_b[DFF + c0 + i]; }
    const int lr0 = run * 16;
    const int grow0 = chunk_row0 + lr0, sb = seq_base_of_row(grow0), T = seq_len_of_row(grow0);
    const int t0 = grow0 - sb;
    u32x4 gq[3], vq[3];
    const u32x4 zero = (u32x4){0u, 0u, 0u, 0u};
#define GT_LDROW(lr, t, a, b) do { if ((t) >= 0 && (t) < T) { const bf16_t* p_ = H + (size_t)(lr) * DFF2 + c0; a = *(const u32x4*)p_; b = *(const u32x4*)(p_ + DFF); } else { a = zero; b = zero; } } while (0)
    GT_LDROW(lr0 - 1, t0 - 1, gq[0], vq[0]); GT_LDROW(lr0, t0, gq[1], vq[1]);
#pragma unroll 1
    for (int rr = 0; rr < 16; ++rr) {
        GT_LDROW(lr0 + rr + 1, t0 + rr + 1, gq[2], vq[2]);
        float og[8], ov[8];
#pragma unroll
        for (int i = 0; i < 8; ++i) { og[i] = bg[i]; ov[i] = bv[i]; }
#pragma unroll
        for (int j = 0; j < 3; ++j) {
            const unsigned ga[4] = {gq[j].x, gq[j].y, gq[j].z, gq[j].w}, va[4] = {vq[j].x, vq[j].y, vq[j].z, vq[j].w};
#pragma unroll
            for (int i = 0; i < 4; ++i) { og[2 * i] += wg[j][2 * i] * bflo(ga[i]); og[2 * i + 1] += wg[j][2 * i + 1] * bfhi(ga[i]); ov[2 * i] += wv[j][2 * i] * bflo(va[i]); ov[2 * i + 1] += wv[j][2 * i + 1] * bfhi(va[i]); }
        }
        u32x4 w; w.x = pk2(gelu_tanh(og[0]) * ov[0], gelu_tanh(og[1]) * ov[1]); w.y = pk2(gelu_tanh(og[2]) * ov[2], gelu_tanh(og[3]) * ov[3]);
        w.z = pk2(gelu_tanh(og[4]) * ov[4], gelu_tanh(og[5]) * ov[5]); w.w = pk2(gelu_tanh(og[6]) * ov[6], gelu_tanh(og[7]) * ov[7]);
        *(u32x4*)(G + (size_t)(lr0 + rr) * DFF + c0) = w;
        gq[0] = gq[1]; gq[1] = gq[2]; vq[0] = vq[1]; vq[1] = vq[2];
    }
}


enum { K_Z = 0, K_Q = 1, K_KV = 2, K_RES = 3, K_H = 4 };
struct EpiAny {
    static constexpr bool AFTER_DRAIN = false;
    int kind; bool perm; unsigned char* ws; float* X; int ldc;
    DEVI void operator()(const pg8::f32x4 (&acc)[2][2][4][2], const pg8::Unit& u, int wr, int wc, int fr, int fq) const {
        if (kind == K_Z) { EpiZ E{(bf16_t*)(ws + WS_Z), (bf16_t*)(ws + WS_VAT), (float*)(ws + WS_SSQQ), (float*)(ws + WS_SSQKV)}; E(acc, u, wr, wc, fr, fq); }
        else if (kind == K_Q) { EpiQ E{(bf16_t*)(ws + WS_QB), (const float*)(ws + WS_SSQQ), (const f32x2*)(ws + WS_ROPE)}; E(acc, u, wr, wc, fr, fq); }
        else if (kind == K_KV) { EpiKV E{(bf16_t*)(ws + WS_KF), (bf16_t*)(ws + WS_VT), (const float*)(ws + WS_SSQKV)}; E(acc, u, wr, wc, fr, fq); }
        else if (kind == K_RES) { EpiRes E{X}; E(acc, u, wr, wc, fr, fq); }
        else { EpiH E{(bf16_t*)(ws + WS_H), ldc}; E(acc, u, wr, wc, fr, fq); }
    }
};

constexpr int LDS_BYTES = 147456, NPH_LAYER = 15, NPHASE = 1 + DEPTH * NPH_LAYER;
#ifndef SUB_MASK
#define SUB_MASK 0xFFFF
#endif
#define SUB(b) (((SUB_MASK) >> (b)) & 1)

__device__ const float INVF[16] = {1.0f, 0.5623413324356079f, 0.3162277638912201f, 0.17782793939113617f, 0.10000000149011612f, 0.05623413249850273f, 0.03162277489900589f, 0.017782794311642647f, 0.009999999776482582f, 0.005623413249850273f, 0.003162277629598975f, 0.0017782794311642647f, 0.0010000000474974513f, 0.000562341301701963f, 0.0003162277571391314f, 0.00017782794020604342f};
typedef __attribute__((address_space(4))) Args CArgs;
__global__ void __launch_bounds__(512, 2) mk_fwd(Args args) {
    extern __shared__ __attribute__((aligned(16))) unsigned char lds[];
    const int wave = __builtin_amdgcn_readfirstlane((int)threadIdx.x >> 6);
    const int G = gridDim.x, bx = blockIdx.x;
    const int vcu = (G % 8 == 0) ? (bx % 8) * (G / 8) + bx / 8 : bx;
    const int gw = vcu * 8 + wave, NGW = G * 8;
#if !MK_MULTI
    cg::grid_group grid = cg::this_grid();
#endif
    if (args.ph_lo == 0) {
        const CArgs* ap = (const CArgs*)__builtin_amdgcn_kernarg_segment_ptr(); unsigned char* const ws = ap->ws; const int tid = ltid(), lane = tid & 63;
            float* scr = (float*)(lds + wave * 16384);
#pragma unroll 1
            for (int ll = 0; ll < DEPTH; ++ll) {
                unsigned char* wq = ws + WS_W + ll * W_LAYER;
                const float* w_in = ap->in[4] + (size_t)ll * DM * DIN; const float* w_out = ap->in[14] + (size_t)ll * DM * DM;
                const float* w_up = ap->in[17] + (size_t)ll * DM * DFF2; const float* w_down = ap->in[20] + (size_t)ll * DFF * DM;
                const float* w_uq = ap->in[7] + (size_t)ll * 256 * 384; const float* w_ukv = ap->in[9] + (size_t)ll * 128 * 512;
                constexpr int I_IN = 16 * 61, I_OUT = 16 * 32, I_UP = 16 * 176, I_DOWN = 44 * 32, I_UQ = 4 * 12, I_UKV = 2 * 16, NIT = I_IN + I_OUT + I_UP + I_DOWN + I_UQ + I_UKV;
#pragma unroll 1
                for (int it = gw; it < NIT; it += NGW) {
                    int q = it; const float* W; int K, N; bf16_t* WT; const float* ksc = nullptr;
                    if (q < I_IN) { W = w_in; K = DM; N = DIN; WT = (bf16_t*)(wq + WO_IN); }
                    else if ((q -= I_IN) < I_OUT) { W = w_out; K = DM; N = DM; WT = (bf16_t*)(wq + WO_OUT); }
                    else if ((q -= I_OUT) < I_UP) { W = w_up; K = DM; N = DFF2; WT = (bf16_t*)(wq + WO_UP); }
                    else if ((q -= I_UP) < I_DOWN) { W = w_down; K = DFF; N = DM; WT = (bf16_t*)(wq + WO_DOWN); }
                    else if ((q -= I_DOWN) < I_UQ) { W = w_uq; K = 256; N = 384; WT = (bf16_t*)(wq + WO_UQ); ksc = ap->in[6] + ll * 256; }
                    else { q -= I_UQ; W = w_ukv; K = 128; N = 512; WT = (bf16_t*)(wq + WO_UKV); ksc = ap->in[8] + ll * 128; }
                    transpose_item(W, K, N, WT, ksc, scr, q, lane);
                }
                { u32x4* pz = (u32x4*)(wq + WO_IN + (size_t)DIN * DM * 2); const int n = 96 * DM * 2 / 16; for (int i = vcu * 512 + tid; i < n; i += G * 512) pz[i] = (u32x4){0u, 0u, 0u, 0u}; }
                { u32x4* pz = (u32x4*)(wq + WO_UQ + (size_t)384 * 256 * 2); const int n = 128 * 256 * 2 / 16; for (int i = vcu * 512 + tid; i < n; i += G * 512) pz[i] = (u32x4){0u, 0u, 0u, 0u}; }
                { const float* sw = ap->in[12] + (size_t)ll * 65536; bf16_t* dst = (bf16_t*)(ws + WS_WSG) + (size_t)ll * 65536; for (int i = vcu * 512 + tid; i < 65536; i += G * 512) dst[i] = f2bf(sw[i]); }
            }
            { f32x2* rope = (f32x2*)(ws + WS_ROPE);
              for (int i = vcu * 512 + tid; i < 16384 * 16; i += G * 512) {
                const int t = i >> 4, f = i & 15; const float invf = INVF[f];
                const float ang = (float)t * invf; const double a = (double)ang; const double k = rint(a * 0.15915494309189535); const float rr = (float)(a - k * 6.283185307179586);
                rope[i] = (f32x2){cosf(rr), sinf(rr)};
              } }
            { f32x2* tw4k = (f32x2*)(ws + WS_TW4K); f32x2* tw16k = (f32x2*)(ws + WS_TW16K);
              for (int i = vcu * 512 + tid; i < 4096; i += G * 512) tw4k[i] = (f32x2){cospif((float)i * (2.0f / 4096.0f)), sinpif((float)i * (2.0f / 4096.0f))};
              for (int i = vcu * 512 + tid; i < 16384; i += G * 512) tw16k[i] = (f32x2){cospif((float)i * (2.0f / 16384.0f)), sinpif((float)i * (2.0f / 16384.0f))}; }
            { bf16_t* D64c = (bf16_t*)(ws + WS_D64C); bf16_t* D64s = (bf16_t*)(ws + WS_D64S); bf16_t* D128c = (bf16_t*)(ws + WS_D128C); bf16_t* D128s = (bf16_t*)(ws + WS_D128S);
              for (int i = vcu * 512 + tid; i < 4096; i += G * 512) { const int a = i >> 6, b = i & 63; const float x = (float)((a * b) & 63) * (2.0f / 64.0f); D64c[i] = f2bf(cospif(x)); D64s[i] = f2bf(sinpif(x)); }
              for (int i = vcu * 512 + tid; i < 16384; i += G * 512) { const int a = i >> 7, b = i & 127; const float x = (float)((a * b) & 127) * (2.0f / 128.0f); D128c[i] = f2bf(cospif(x)); D128s[i] = f2bf(sinpif(x)); } }
            { float* ssq_q = (float*)(ws + WS_SSQQ); float* ssq_kv = (float*)(ws + WS_SSQKV);
              for (int i = vcu * 512 + tid; i < MTOK; i += G * 512) { ssq_q[i] = 0.f; ssq_kv[i] = 0.f; } }
            { float* X = ap->out; bf16_t* XB = (bf16_t*)(ws + WS_XB);
#pragma unroll 1
              for (int m = gw; m < MTOK; m += NGW) { const float* src = (m < NPROMPT) ? ap->in[0] + (size_t)m * DM : ap->in[1] + (size_t)(m - NPROMPT) * DM;
                ln_row(src, X + (size_t)m * DM, XB + (size_t)m * DM, ap->in[2], ap->in[3], lane); } }
        }
#if !MK_MULTI
    if (args.ph_hi > 1) grid.sync();
#endif
#pragma unroll 1
    for (int p = max(args.ph_lo, 1); p < args.ph_hi; ++p) {
        const CArgs* ap = (const CArgs*)__builtin_amdgcn_kernarg_segment_ptr(); asm volatile("" : "+s"(ap));
        unsigned char* const ws = ap->ws;
        const int tid = ltid(), lane = tid & 63;
        const int l = (p - 1) / NPH_LAYER, r = (p - 1) % NPH_LAYER;
        unsigned char* wl = ws + WS_W + l * W_LAYER;
        int ng = 0;
        if (r == 0 || r == 3) ng = 1; else if (r == 1) ng = 2; else if (r >= 5 && r <= 13 && (r - 5) % 3 != 1) ng = 1;
#pragma unroll 1
        for (int j = 0; j < ng; ++j) {
            pg8::Gemm g; EpiAny E; E.ws = ws; E.X = ap->out; E.ldc = DFF2;
            if (r == 0) { g = pg8::Gemm{(const bf16_t*)(ws + WS_XB), (const bf16_t*)(wl + WO_IN), MTOK, ZP, DM, DM}; E.kind = K_Z; E.perm = true; }
            else if (r == 1 && j == 0) { g = pg8::Gemm{(const bf16_t*)(ws + WS_Z) + C_CQ, (const bf16_t*)(wl + WO_UQ), MTOK, 512, 256, ZP}; E.kind = K_Q; E.perm = false; }
            else if (r == 1) { g = pg8::Gemm{(const bf16_t*)(ws + WS_Z) + C_CKV, (const bf16_t*)(wl + WO_UKV), MTOK, 512, 128, ZP}; E.kind = K_KV; E.perm = true; }
            else if (r == 3) { g = pg8::Gemm{(const bf16_t*)(ws + WS_MIX), (const bf16_t*)(wl + WO_OUT), MTOK, DM, DM, DM}; E.kind = K_RES; E.perm = false; }
            else { const int c = (r - 5) / 3; const size_t r0 = (size_t)c * CHUNK_ROWS;
                if ((r - 5) % 3 == 0) { g = pg8::Gemm{(const bf16_t*)(ws + WS_XB) + r0 * DM, (const bf16_t*)(wl + WO_UP), CHUNK_ROWS, DFF2, DM, DM}; E.kind = K_H; E.perm = true; }
                else { g = pg8::Gemm{(const bf16_t*)(ws + WS_G), (const bf16_t*)(wl + WO_DOWN), CHUNK_ROWS, DM, DFF, DFF}; E.kind = K_RES; E.perm = false; E.X = ap->out + r0 * DM; } }
            pg8::StaticOrder S; S.init(g.M, g.N, G, bx);
            pg8::gemm_phase<EpiAny, pg8::StaticOrder, true, true>((PG8_LAS unsigned char*)lds, g, S, E);
        }
        if (r == 1) {
            if (SUB(2)) { const bf16_t* Z = (const bf16_t*)(ws + WS_Z); bf16_t* Kf = (bf16_t*)(ws + WS_KF); const f32x2* rope = (const f32x2*)(ws + WS_ROPE);
#pragma unroll 1
              for (int i = vcu * 512 + tid; i < MTOK * 16; i += G * 512) {
                const int row = i >> 4, f = i & 15; const int t = row - seq_base_of_row(row); const f32x2 cs = rope[t * 16 + f];
                const float x1 = bf2f(Z[(size_t)row * ZP + C_KR + f]), x2 = bf2f(Z[(size_t)row * ZP + C_KR + 16 + f]);
                const bf16_t y1 = f2bf(x1 * cs.x - x2 * cs.y), y2 = f2bf(x1 * cs.y + x2 * cs.x);
#pragma unroll
                for (int h = 0; h < 4; ++h) { Kf[(size_t)row * QW + h * 96 + 64 + f] = y1; Kf[(size_t)row * QW + h * 96 + 80 + f] = y2; }
              } }
            if (SUB(3)) {
                const bf16_t* Z = (const bf16_t*)(ws + WS_Z); const bf16_t* VaT = (const bf16_t*)(ws + WS_VAT); bf16_t* MIX = (bf16_t*)(ws + WS_MIX);
                float* rpbs = (float*)(lds + 49152);
                const float* rpb = ap->in[5] + (size_t)l * 4 * 15 * 31;
#pragma unroll 1
                for (int u = vcu; u < 192 * 4; u += G) {
                    const int h = u & 3, rgq = u >> 2; const int gm0 = rgq * 256, sb = seq_base_of_row(gm0), T = seq_len_of_row(gm0), rows = T / 64;
                    const int r0 = (gm0 - sb) / 64;
                    __syncthreads();
                    for (int i = tid; i < 15 * 32; i += 512) { const int a = i >> 5, b = i & 31; rpbs[i] = (b < 31) ? rpb[(h * 15 + a) * 31 + b] * LOG2E : 0.f; }
                    const int kr0 = min(max(r0 - 4, 0), rows - 8), krl = min(max(r0 + 3 - 4, 0), rows - 8) + 7, nkt = krl - kr0 + 1;
                    const int rq = r0 + (wave >> 1), rs = min(max(rq - 4, 0), rows - 8), j_lo = rs - kr0, rioff = rs - rq + 7 - j_lo;
                    attn_unit<64, true>(lds, Z + (size_t)(gm0 + 32 * wave) * ZP + C_QA + h * 64, ZP, Z + (size_t)(sb + kr0 * 64) * ZP + C_KA + h * 64, ZP,
                                        VaT + (size_t)sb * 256 + (size_t)(h * 64) * T + kr0 * 64, T, nkt, MIX + (size_t)(gm0 + 32 * wave) * DM + h * 64, DM, rpbs, j_lo, rioff);
                }
            }
            if (SUB(4)) {
#pragma unroll 1
              for (int it = vcu; it < 384 * 4; it += G)
                sgu_item(lds, it, (const bf16_t*)(ws + WS_Z), (const bf16_t*)(ws + WS_WSG) + (size_t)l * 65536, ap->in[10] + l * 256, ap->in[11] + l * 256, ap->in[13] + (size_t)l * 512, (bf16_t*)(ws + WS_MIX)); }
            if (SUB(5)) {
              const bf16_t* Z = (const bf16_t*)(ws + WS_Z); bf16_t* FAre = (bf16_t*)(ws + WS_FARE); bf16_t* FAim = (bf16_t*)(ws + WS_FAIM);
#pragma unroll 1
              for (int it = vcu; it < 384; it += G) {
                if (it < 128) fft1_item<128>(lds, NPROMPT, it >> 3, it & 7, Z, (const bf16_t*)(ws + WS_D128C), (const bf16_t*)(ws + WS_D128S), (const f32x2*)(ws + WS_TW16K), FAre, FAim);
                else { const int q = it - 128; fft1_item<64>(lds, (q >> 5) * 4096, (q >> 2) & 7, q & 3, Z, (const bf16_t*)(ws + WS_D64C), (const bf16_t*)(ws + WS_D64S), (const f32x2*)(ws + WS_TW4K), FAre, FAim); }
              } }
        }
        if (r == 2) {
            if (SUB(6)) { const bf16_t* Qb = (const bf16_t*)(ws + WS_QB); const bf16_t* Kf = (const bf16_t*)(ws + WS_KF); const bf16_t* VT = (const bf16_t*)(ws + WS_VT); bf16_t* MIX = (bf16_t*)(ws + WS_MIX);
#pragma unroll 1
              for (int u = vcu; u < 768; u += G) {
                int sb, T, h, qb;
                if (u < 256) { sb = NPROMPT; T = 16384; h = u >> 6; qb = u & 63; }
                else { const int q = u - 256; const int sh = q >> 4; sb = (sh >> 2) * 4096; T = 4096; h = sh & 3; qb = q & 15; }
                attn_unit<96, false>(lds, Qb + (size_t)(sb + qb * 256 + 32 * wave) * QW + h * 96, QW, Kf + (size_t)sb * QW + h * 96, QW,
                                     VT + (size_t)sb * 256 + (size_t)(h * 64) * T, T, T / 64, MIX + (size_t)(sb + qb * 256 + 32 * wave) * DM + 512 + h * 64, DM, nullptr, 0, 0);
              } }
            if (SUB(7)) { const bf16_t* FAre = (const bf16_t*)(ws + WS_FARE); const bf16_t* FAim = (const bf16_t*)(ws + WS_FAIM); bf16_t* MIX = (bf16_t*)(ws + WS_MIX);
              const bf16_t* D64c = (const bf16_t*)(ws + WS_D64C); const bf16_t* D64s = (const bf16_t*)(ws + WS_D64S);
#pragma unroll 1
              for (int it = vcu; it < 2560; it += G) {
                if (it < 512) fft2_item<128>(lds, NPROMPT, it >> 2, it & 3, FAre, FAim, (const bf16_t*)(ws + WS_D128C), (const bf16_t*)(ws + WS_D128S), D64c, D64s, MIX);
                else { const int q = it - 512; fft2_item<64>(lds, (q >> 8) * 4096, (q >> 2) & 63, q & 3, FAre, FAim, D64c, D64s, D64c, D64s, MIX); }
              } }
        }
        if (r == 4 || r == 14) {
            float* X = ap->out; bf16_t* XB = (bf16_t*)(ws + WS_XB);
            const float* gg = ap->in[r == 4 ? 15 : 21] + l * DM; const float* bb = ap->in[r == 4 ? 16 : 22] + l * DM;
#pragma unroll 1
            for (int m = gw; m < MTOK; m += NGW) ln_row(X + (size_t)m * DM, X + (size_t)m * DM, XB + (size_t)m * DM, gg, bb, lane);
            if (r == 4) { float* ssq_q = (float*)(ws + WS_SSQQ); float* ssq_kv = (float*)(ws + WS_SSQKV);
                for (int i = vcu * 512 + tid; i < MTOK; i += G * 512) { ssq_q[i] = 0.f; ssq_kv[i] = 0.f; } }
        }
        if (r >= 5 && r <= 13 && (r - 5) % 3 == 1) {
            const int c = (r - 5) / 3;
            const float* cw = ap->in[18] + (size_t)l * 3 * DFF2; const float* cb = ap->in[19] + (size_t)l * DFF2;
#pragma unroll 1
            for (int it = gw; it < (CHUNK_ROWS / 16) * 6; it += NGW) gate_item(it, c * CHUNK_ROWS, (const bf16_t*)(ws + WS_H), (bf16_t*)(ws + WS_G), cw, cb, lane);
        }
#if !MK_MULTI
        if (p + 1 < args.ph_hi) grid.sync();
#endif
    }
}


extern "C" void kernel_launch(void* const* d_in, const int* in_sizes, int n_in, void* d_out, int out_size, void* d_ws, size_t ws_size, hipStream_t stream) {
    static int grid = 0;
    if (grid == 0) {
        if (n_in != 23 || out_size != MTOK * DM || ws_size < WS_END) { fprintf(stderr, "kernel_launch: unexpected shapes (n_in %d out %d ws %zu)\n", n_in, out_size, ws_size); grid = -1; return; }
        int dev = 0, cus = 0, per_cu = 0;
        hipGetDevice(&dev); hipDeviceGetAttribute(&cus, hipDeviceAttributeMultiprocessorCount, dev);
        hipFuncSetAttribute((const void*)mk_fwd, hipFuncAttributeMaxDynamicSharedMemorySize, LDS_BYTES);
        hipOccupancyMaxActiveBlocksPerMultiprocessor(&per_cu, (const void*)mk_fwd, 512, LDS_BYTES);
        (void)hipGetLastError();
        if (per_cu < 1) per_cu = 1;
        grid = cus;
    }
    if (grid < 0) return;
    Args a{};
    for (int i = 0; i < 23; ++i) a.in[i] = (const float*)d_in[i];
    a.out = (float*)d_out; a.ws = (unsigned char*)d_ws;
#if MK_MULTI
    for (int p = 0; p < NPHASE; ++p) { a.ph_lo = p; a.ph_hi = p + 1; hipLaunchKernelGGL(mk_fwd, dim3(grid), dim3(512), LDS_BYTES, stream, a); }
#else
    a.ph_lo = 0; a.ph_hi = NPHASE;
    void* kargs[] = {&a};
    hipError_t e = hipLaunchCooperativeKernel((const void*)mk_fwd, dim3(grid), dim3(512), kargs, LDS_BYTES, stream);
    if (e != hipSuccess) fprintf(stderr, "cooperative launch failed: %s (grid %d)\n", hipGetErrorString(e), grid);
#endif
}
```
